# Optimizing an MI355X kernel written in HIP

```python
import math
import jax, jax.numpy as jnp
from jax import lax
import numpy as np

D_MODEL = 1024
BATCH = 4
SEQ = 4096
DEPTH = 1

CHUNK = 64
Q_BLOCK = 128

DSA_WIDTH = D_MODEL // 2
DSA_HEAD_DIM = 64
DSA_HEADS = DSA_WIDTH // DSA_HEAD_DIM
IDX_HEADS = 8
IDX_DIM = 64
TOPK_MAX = 256

HG_WIDTH = D_MODEL - DSA_WIDTH
HG_DK = 128
HG_HEADS = HG_WIDTH // HG_DK
HG_DV = HG_WIDTH // HG_HEADS

D_FF = ((8 * D_MODEL // 3 + 255) // 256) * 256

ALPHA = (2.0 * DEPTH) ** 0.25
BETA = (8.0 * DEPTH) ** -0.25
LN_EPS = 1e-5
RMS_EPS = 1e-6

SPLIT_SIZES = (DSA_WIDTH, DSA_WIDTH, DSA_WIDTH, IDX_HEADS * IDX_DIM, IDX_DIM, IDX_HEADS,
               HG_HEADS * HG_DK, HG_HEADS * HG_DK, HG_WIDTH, HG_WIDTH)
D_PROJ = sum(SPLIT_SIZES)

kernel_name = "hybrid_dsa_hgrn2_deepnorm_block"


def _split_points():
    pts, acc = [], 0
    for s in SPLIT_SIZES[:-1]:
        acc += s
        pts.append(acc)
    return pts


def _layer_norm(x, g, b):
    xf = x.astype(jnp.float32)
    mu = jnp.mean(xf, axis=-1, keepdims=True)
    var = jnp.mean(jnp.square(xf - mu), axis=-1, keepdims=True)
    y = (xf - mu) * lax.rsqrt(var + LN_EPS) * g.astype(jnp.float32) + b.astype(jnp.float32)
    return y.astype(x.dtype)


def _alibi_slopes(n):
    return 2.0 ** (-8.0 * jnp.arange(1, n + 1, dtype=jnp.float32) / n)


def _dsa_attention(q, k, v, iq, ik, iw):
    B, S = q.shape[0], q.shape[1]
    topk = min(TOPK_MAX, S // 4)
    n_blk = S // Q_BLOCK
    slopes = _alibi_slopes(DSA_HEADS)
    key_pos = jnp.arange(S, dtype=jnp.int32)
    scale = DSA_HEAD_DIM ** -0.5
    idx_scale = (IDX_DIM ** -0.5) * (IDX_HEADS ** -0.5)
    gather = jax.vmap(lambda t, i: t[i])

    def block(bi):
        start = bi * Q_BLOCK
        qb = lax.dynamic_slice_in_dim(q, start, Q_BLOCK, axis=1)
        iqb = lax.dynamic_slice_in_dim(iq, start, Q_BLOCK, axis=1)
        iwb = lax.dynamic_slice_in_dim(iw, start, Q_BLOCK, axis=1)
        qpos = start + jnp.arange(Q_BLOCK, dtype=jnp.int32)
        limit = (qpos // CHUNK + 1) * CHUNK
        adm = key_pos[None, :] < limit[:, None]
        rel = jax.nn.relu(jnp.einsum('bqhd,bsd->bqhs', iqb, ik).astype(jnp.float32))
        score = jnp.einsum('bqh,bqhs->bqs', iwb.astype(jnp.float32), rel) * idx_scale
        score = jnp.where(adm[None], score, -jnp.inf)
        _, sel = lax.top_k(score, topk)
        kg = gather(k, sel)
        vg = gather(v, sel)
        logits = jnp.einsum('bqhd,bqkhd->bhqk', qb, kg).astype(jnp.float32) * scale
        dist = jnp.abs(qpos[None, :, None] - sel).astype(jnp.float32)
        logits = logits - slopes[None, :, None, None] * dist[:, None]
        valid = sel < limit[None, :, None]
        logits = jnp.where(valid[:, None], logits, -jnp.inf)
        p = jax.nn.softmax(logits, axis=-1).astype(v.dtype)
        return jnp.einsum('bhqk,bqkhd->bqhd', p, vg)

    out = lax.map(block, jnp.arange(n_blk))
    return out.transpose(1, 0, 2, 3, 4).reshape(B, S, DSA_HEADS * DSA_HEAD_DIM)


def _hgrn2(q, f_logit, inp, lb):
    f32 = jnp.float32
    B, S, H, Dk = q.shape
    Dv = inp.shape[-1]
    nc = S // CHUNK
    f = lb + (1.0 - lb) * jax.nn.sigmoid(f_logit.astype(f32))
    logf = jnp.log(f)
    kk = 1.0 - f

    def to_chunks(t):
        return t.reshape(B, nc, CHUNK, t.shape[2], t.shape[3]).transpose(1, 0, 3, 2, 4)

    tri = jnp.tril(jnp.ones((CHUNK, CHUNK), dtype=bool))

    def step(state, xs):
        qc, lfc, kc, vc = xs
        G = jnp.cumsum(lfc, axis=2)
        diff = G[:, :, :, None, :] - G[:, :, None, :, :]
        decay = jnp.exp(jnp.where(tri[:, :, None], diff, -jnp.inf))
        A = jnp.einsum('bhtk,bhtsk,bhsk->bhts', qc, decay, kc)
        o = jnp.einsum('bhts,bhsv->bhtv', A, vc) + \
            jnp.einsum('bhtk,bhkv->bhtv', qc * jnp.exp(G), state)
        G_last = G[:, :, -1:, :]
        state = jnp.exp(G_last[:, :, 0])[..., None] * state + \
            jnp.einsum('bhsk,bhsv->bhkv', kc * jnp.exp(G_last - G), vc)
        return state, o

    s0 = jnp.zeros((B, H, Dk, Dv), f32)
    _, o = lax.scan(step, s0, (to_chunks(q.astype(f32)), to_chunks(logf),
                               to_chunks(kk), to_chunks(inp.astype(f32))))
    return o.transpose(1, 0, 3, 2, 4).reshape(B, S, H, Dv)


def setup_inputs(seed: int = 0) -> dict:
    key = jax.random.key(seed)
    keys = jax.random.split(key, 16)
    f32 = jnp.float32
    x = jax.random.normal(keys[0], (BATCH, SEQ, D_MODEL), f32)
    col_scale = []
    for j, s in enumerate(SPLIT_SIZES):
        col_scale.append(jnp.full((s,), BETA if j in (2, 8) else 1.0, f32))
    col_scale = jnp.concatenate(col_scale)
    w_in = jax.random.normal(keys[1], (DEPTH, D_MODEL, D_PROJ), f32) * (D_MODEL ** -0.5) * col_scale
    w_out = jax.random.normal(keys[2], (DEPTH, D_MODEL, D_MODEL), f32) * (D_MODEL ** -0.5) * BETA
    hg_lb_logits = 0.1 * jax.random.normal(keys[3], (DEPTH + 1, HG_HEADS * HG_DK), f32)
    hg_norm_g = 1.0 + 0.02 * jax.random.normal(keys[4], (DEPTH, HG_WIDTH), f32)
    ln1_g = 1.0 + 0.02 * jax.random.normal(keys[5], (DEPTH, D_MODEL), f32)
    ln1_b = 0.02 * jax.random.normal(keys[6], (DEPTH, D_MODEL), f32)
    w_gate = jax.random.normal(keys[7], (DEPTH, D_MODEL, D_FF), f32) * (D_MODEL ** -0.5) * BETA
    w_up = jax.random.normal(keys[8], (DEPTH, D_MODEL, D_FF), f32) * (D_MODEL ** -0.5) * BETA
    w_down = jax.random.normal(keys[9], (DEPTH, D_FF, D_MODEL), f32) * (D_FF ** -0.5) * BETA
    ln2_g = 1.0 + 0.02 * jax.random.normal(keys[10], (DEPTH, D_MODEL), f32)
    ln2_b = 0.02 * jax.random.normal(keys[11], (DEPTH, D_MODEL), f32)
    return {"x": x, "w_in": w_in, "w_out": w_out, "hg_lb_logits": hg_lb_logits,
            "hg_norm_g": hg_norm_g, "ln1_g": ln1_g, "ln1_b": ln1_b, "w_gate": w_gate,
            "w_up": w_up, "w_down": w_down, "ln2_g": ln2_g, "ln2_b": ln2_b}


def reference(x, w_in, w_out, hg_lb_logits, hg_norm_g, ln1_g, ln1_b, w_gate, w_up, w_down, ln2_g, ln2_b):
    B, S, _ = x.shape
    f32 = jnp.float32
    lb_all = jnp.cumsum(jax.nn.softmax(hg_lb_logits.astype(f32), axis=0), axis=0)
    pts = _split_points()
    for l in range(DEPTH):
        proj = x @ w_in[l]
        dq, dk, dv, iq, ik, iw, hq, hf, hi, hg = jnp.split(proj, pts, axis=-1)
        a = _dsa_attention(dq.reshape(B, S, DSA_HEADS, DSA_HEAD_DIM),
                           dk.reshape(B, S, DSA_HEADS, DSA_HEAD_DIM),
                           dv.reshape(B, S, DSA_HEADS, DSA_HEAD_DIM),
                           iq.reshape(B, S, IDX_HEADS, IDX_DIM), ik, iw)
        lb = lb_all[l].reshape(HG_HEADS, HG_DK)
        o = _hgrn2(hq.reshape(B, S, HG_HEADS, HG_DK), hf.reshape(B, S, HG_HEADS, HG_DK),
                   hi.reshape(B, S, HG_HEADS, HG_DV), lb)
        o = o * lax.rsqrt(jnp.mean(jnp.square(o), axis=-1, keepdims=True) + RMS_EPS)
        r = o.reshape(B, S, HG_WIDTH) * hg_norm_g[l].astype(f32) * jax.nn.silu(hg.astype(f32))
        mix = jnp.concatenate([a, r.astype(x.dtype)], axis=-1) @ w_out[l]
        x = _layer_norm(ALPHA * x + mix, ln1_g[l], ln1_b[l])
        ff = (jax.nn.silu(x @ w_gate[l]) * (x @ w_up[l])) @ w_down[l]
        x = _layer_norm(ALPHA * x + ff, ln2_g[l], ln2_b[l])
    return x
```

```cpp
#include <hip/hip_runtime.h>
#include <cstdio>
#include <cstdint>

namespace nv {
constexpr int D = 1024, NB = 4, S = 4096;
constexpr int DP = 4168, FF = 2816;
constexpr int OFF_Q = 0, OFF_K = 512, OFF_V = 1024, OFF_IQ = 1536, OFF_IK = 2048, OFF_IW = 2112, OFF_HQ = 2120, OFF_HF = 2632, OFF_HI = 3144, OFF_HG = 3656;
constexpr float ALPHA = 1.189207115002721f;
constexpr float LN_EPS = 1e-5f, RMS_EPS = 1e-6f;

__global__ void __launch_bounds__(256) sgemm(const float* __restrict__ A, int lda, const float* __restrict__ Bm, int ldb, float* __restrict__ C, int ldc, int M, int N, int K) {
    __shared__ float As[16][128 + 4];
    __shared__ float Bs[16][128 + 4];
    const int tid = threadIdx.x, tx = tid & 15, ty = tid >> 4;
    const int m0 = blockIdx.y * 128, n0 = blockIdx.x * 128;
    float acc[8][8];
#pragma unroll
    for (int i = 0; i < 8; ++i)
#pragma unroll
        for (int j = 0; j < 8; ++j) acc[i][j] = 0.f;
    for (int k0 = 0; k0 < K; k0 += 16) {
#pragma unroll
        for (int i = 0; i < 2; ++i) {
            const int f = tid + i * 256, r = f >> 2, c4 = (f & 3) * 4;
            const float4 v = *(const float4*)(A + (size_t)(m0 + r) * lda + k0 + c4);
            As[c4 + 0][r] = v.x; As[c4 + 1][r] = v.y; As[c4 + 2][r] = v.z; As[c4 + 3][r] = v.w;
        }
#pragma unroll
        for (int i = 0; i < 2; ++i) {
            const int f = tid + i * 256, r = f >> 5, c4 = (f & 31) * 4;
            float4 v = make_float4(0.f, 0.f, 0.f, 0.f);
            if (n0 + c4 < N) v = *(const float4*)(Bm + (size_t)(k0 + r) * ldb + n0 + c4);
            *(float4*)&Bs[r][c4] = v;
        }
        __syncthreads();
#pragma unroll
        for (int k = 0; k < 16; ++k) {
            float a[8], b[8];
            const float4 a0 = *(const float4*)&As[k][ty * 8], a1 = *(const float4*)&As[k][ty * 8 + 4];
            const float4 b0 = *(const float4*)&Bs[k][tx * 8], b1 = *(const float4*)&Bs[k][tx * 8 + 4];
            a[0] = a0.x; a[1] = a0.y; a[2] = a0.z; a[3] = a0.w; a[4] = a1.x; a[5] = a1.y; a[6] = a1.z; a[7] = a1.w;
            b[0] = b0.x; b[1] = b0.y; b[2] = b0.z; b[3] = b0.w; b[4] = b1.x; b[5] = b1.y; b[6] = b1.z; b[7] = b1.w;
#pragma unroll
            for (int i = 0; i < 8; ++i)
#pragma unroll
                for (int j = 0; j < 8; ++j) acc[i][j] = fmaf(a[i], b[j], acc[i][j]);
        }
        __syncthreads();
    }
#pragma unroll
    for (int i = 0; i < 8; ++i) {
        const int r = m0 + ty * 8 + i;
#pragma unroll
        for (int j = 0; j < 8; j += 4) {
            const int c = n0 + tx * 8 + j;
            if (c < N) *(float4*)(C + (size_t)r * ldc + c) = make_float4(acc[i][j], acc[i][j + 1], acc[i][j + 2], acc[i][j + 3]);
        }
    }
}

__device__ __forceinline__ float wave_max(float v) {
#pragma unroll
    for (int o = 1; o < 64; o <<= 1) v = fmaxf(v, __shfl_xor(v, o));
    return v;
}
__device__ __forceinline__ float wave_sum(float v) {
#pragma unroll
    for (int o = 1; o < 64; o <<= 1) v += __shfl_xor(v, o);
    return v;
}

__global__ void __launch_bounds__(256) dsa_naive(const float* __restrict__ proj, float* __restrict__ cat) {
    const int t = blockIdx.x, tid = threadIdx.x, lane = tid & 63, wid = tid >> 6;
    __shared__ float s_iq[512];
    __shared__ float s_q[512];
    __shared__ float s_iw[8];
    __shared__ unsigned s_key[4096];
    __shared__ int s_sel[256];
    __shared__ float s_p[256];
    __shared__ float s_red[4];
    __shared__ int s_cnt[2];
    __shared__ int s_pre[256];
    __shared__ int s_pre2[256];
    __shared__ float s_part[4][64];
    const float* prow = proj + (size_t)t * DP;
    for (int i = tid; i < 512; i += 256) { s_iq[i] = prow[OFF_IQ + i]; s_q[i] = prow[OFF_Q + i]; }
    if (tid < 8) s_iw[tid] = prow[OFF_IW + tid];
    if (tid < 2) s_cnt[tid] = 0;
    __syncthreads();
    const int limit = (t / 64 + 1) * 64;
    int nsel;
    if (limit <= 256) {
        if (tid < limit) s_sel[tid] = tid;
        nsel = limit;
        __syncthreads();
    } else {
        const float idx_scale = 0.125f * 0.35355339059327373f;
        for (int s = tid; s < limit; s += 256) {
            const float* kr = proj + (size_t)s * DP + OFF_IK;
            float kreg[64];
#pragma unroll
            for (int d = 0; d < 64; d += 4) { const float4 v = *(const float4*)(kr + d); kreg[d] = v.x; kreg[d + 1] = v.y; kreg[d + 2] = v.z; kreg[d + 3] = v.w; }
            float acc = 0.f;
#pragma unroll
            for (int h = 0; h < 8; ++h) {
                float dot = 0.f;
#pragma unroll
                for (int d = 0; d < 64; ++d) dot = fmaf(s_iq[h * 64 + d], kreg[d], dot);
                acc += s_iw[h] * fmaxf(dot, 0.f);
            }
            float sc = acc * idx_scale;
            if (sc == 0.f) sc = 0.f;
            const unsigned u = __float_as_uint(sc);
            s_key[s] = (u & 0x80000000u) ? ~u : (u | 0x80000000u);
        }
        __syncthreads();
        const int sb = tid * 16;
        unsigned T = 0u;
        for (int bit = 31; bit >= 0; --bit) {
            const unsigned cand = T | (1u << bit);
            int c = 0;
#pragma unroll
            for (int j = 0; j < 16; ++j) { const int s = sb + j; if (s < limit && s_key[s] >= cand) ++c; }
            c = (int)wave_sum((float)c);
            if (lane == 0) atomicAdd(&s_cnt[bit & 1], c);
            __syncthreads();
            const int tot = s_cnt[bit & 1];
            if (tid == 0) s_cnt[(bit & 1) ^ 1] = 0;
            if (tot >= 256) T = cand;
            __syncthreads();
        }
        int cgt = 0, ceq = 0;
#pragma unroll
        for (int j = 0; j < 16; ++j) { const int s = sb + j; if (s < limit) { const unsigned k = s_key[s]; cgt += (k > T); ceq += (k == T); } }
        s_pre[tid] = cgt; s_pre2[tid] = ceq;
        __syncthreads();
        int tot_gt = 0, eq_before = 0;
        for (int i = 0; i < 256; ++i) { const int g = s_pre[i], e = s_pre2[i]; tot_gt += g; if (i < tid) eq_before += e; }
        const int need = 256 - tot_gt;
        __syncthreads();
        int mysel = 0; unsigned selmask = 0u; int er = eq_before;
#pragma unroll
        for (int j = 0; j < 16; ++j) { const int s = sb + j; if (s < limit) { const unsigned k = s_key[s]; bool take = (k > T); if (k == T) { take = (er < need); ++er; } if (take) { selmask |= (1u << j); ++mysel; } } }
        s_pre[tid] = mysel;
        __syncthreads();
        int pos = 0;
        for (int i = 0; i < tid; ++i) pos += s_pre[i];
#pragma unroll
        for (int j = 0; j < 16; ++j) if (selmask & (1u << j)) { if (pos < 256) s_sel[pos] = sb + j; ++pos; }
        nsel = 256;
        __syncthreads();
    }
    for (int h = 0; h < 8; ++h) {
        const float slope = exp2f(-(float)(h + 1));
        float logit = -INFINITY; int sj = 0;
        if (tid < nsel) {
            sj = s_sel[tid];
            const float* kr = proj + (size_t)sj * DP + OFF_K + h * 64;
            float dot = 0.f;
#pragma unroll
            for (int d = 0; d < 64; d += 4) { const float4 v = *(const float4*)(kr + d); dot = fmaf(s_q[h * 64 + d], v.x, dot); dot = fmaf(s_q[h * 64 + d + 1], v.y, dot); dot = fmaf(s_q[h * 64 + d + 2], v.z, dot); dot = fmaf(s_q[h * 64 + d + 3], v.w, dot); }
            logit = dot * 0.125f - slope * fabsf((float)(t - sj));
        }
        float m = wave_max(logit);
        if (lane == 0) s_red[wid] = m;
        __syncthreads();
        m = fmaxf(fmaxf(s_red[0], s_red[1]), fmaxf(s_red[2], s_red[3]));
        __syncthreads();
        const float e = (tid < nsel) ? expf(logit - m) : 0.f;
        float sm = wave_sum(e);
        if (lane == 0) s_red[wid] = sm;
        __syncthreads();
        sm = (s_red[0] + s_red[1]) + (s_red[2] + s_red[3]);
        s_p[tid] = e / sm;
        __syncthreads();
        const int d = tid & 63, part = tid >> 6;
        float acc = 0.f;
        for (int j = part; j < nsel; j += 4) acc = fmaf(s_p[j], proj[(size_t)s_sel[j] * DP + OFF_V + h * 64 + d], acc);
        s_part[part][d] = acc;
        __syncthreads();
        if (tid < 64) cat[(size_t)t * D + h * 64 + tid] = (s_part[0][tid] + s_part[1][tid]) + (s_part[2][tid] + s_part[3][tid]);
        __syncthreads();
    }
}

__global__ void __launch_bounds__(128) hgrn_naive(const float* __restrict__ proj, const float* __restrict__ lbl, float* __restrict__ o) {
    const int h = blockIdx.x, v = threadIdx.x;
    __shared__ float sf[8][128];
    __shared__ float sk[8][128];
    __shared__ float sq[8][128];
    float St[128];
#pragma unroll
    for (int k = 0; k < 128; ++k) St[k] = 0.f;
    const float l0 = lbl[h * 128 + v], l1 = lbl[512 + h * 128 + v];
    const float mx = fmaxf(l0, l1), e0 = expf(l0 - mx), e1 = expf(l1 - mx);
    const float lb = e0 / (e0 + e1);
    for (int t0 = 0; t0 < S; t0 += 8) {
        __syncthreads();
#pragma unroll
        for (int j = 0; j < 8; ++j) {
            const float* pr = proj + (size_t)(t0 + j) * DP;
            const float fl = pr[OFF_HF + h * 128 + v];
            const float f = lb + (1.f - lb) * (1.f / (1.f + expf(-fl)));
            sf[j][v] = f; sk[j][v] = 1.f - f; sq[j][v] = pr[OFF_HQ + h * 128 + v];
        }
        __syncthreads();
        for (int j = 0; j < 8; ++j) {
            const float iv = proj[(size_t)(t0 + j) * DP + OFF_HI + h * 128 + v];
            float acc = 0.f;
#pragma unroll
            for (int k = 0; k < 128; ++k) { St[k] = fmaf(sf[j][k], St[k], sk[j][k] * iv); acc = fmaf(St[k], sq[j][k], acc); }
            o[(size_t)(t0 + j) * 512 + h * 128 + v] = acc;
        }
    }
}

__global__ void __launch_bounds__(256) hgrn_post(const float* __restrict__ o, const float* __restrict__ proj, const float* __restrict__ g, float* __restrict__ cat) {
    const int t = blockIdx.x, h = threadIdx.x >> 6, lane = threadIdx.x & 63;
    const float a = o[(size_t)t * 512 + h * 128 + lane], b = o[(size_t)t * 512 + h * 128 + 64 + lane];
    const float ss = wave_sum(a * a + b * b);
    const float r = 1.f / sqrtf(ss * (1.f / 128.f) + RMS_EPS);
    const float ga = proj[(size_t)t * DP + OFF_HG + h * 128 + lane], gb = proj[(size_t)t * DP + OFF_HG + h * 128 + 64 + lane];
    cat[(size_t)t * D + 512 + h * 128 + lane] = a * r * g[h * 128 + lane] * (ga / (1.f + expf(-ga)));
    cat[(size_t)t * D + 512 + h * 128 + 64 + lane] = b * r * g[h * 128 + 64 + lane] * (gb / (1.f + expf(-gb)));
}

__global__ void __launch_bounds__(256) ln_res(const float* __restrict__ res, const float* __restrict__ add, const float* __restrict__ g, const float* __restrict__ b, float* __restrict__ out) {
    const int r = blockIdx.x, tid = threadIdx.x, lane = tid & 63, wid = tid >> 6;
    __shared__ float red[4];
    const float4 xv = *(const float4*)(res + (size_t)r * D + tid * 4), av = *(const float4*)(add + (size_t)r * D + tid * 4);
    float y[4] = {ALPHA * xv.x + av.x, ALPHA * xv.y + av.y, ALPHA * xv.z + av.z, ALPHA * xv.w + av.w};
    float s = wave_sum((y[0] + y[1]) + (y[2] + y[3]));
    if (lane == 0) red[wid] = s;
    __syncthreads();
    const float mean = ((red[0] + red[1]) + (red[2] + red[3])) * (1.f / D);
    __syncthreads();
    float q = 0.f;
#pragma unroll
    for (int i = 0; i < 4; ++i) { y[i] -= mean; q += y[i] * y[i]; }
    q = wave_sum(q);
    if (lane == 0) red[wid] = q;
    __syncthreads();
    const float rstd = 1.f / sqrtf(((red[0] + red[1]) + (red[2] + red[3])) * (1.f / D) + LN_EPS);
    const float4 gv = *(const float4*)(g + tid * 4), bv = *(const float4*)(b + tid * 4);
    *(float4*)(out + (size_t)r * D + tid * 4) = make_float4(y[0] * rstd * gv.x + bv.x, y[1] * rstd * gv.y + bv.y, y[2] * rstd * gv.z + bv.z, y[3] * rstd * gv.w + bv.w);
}

__global__ void __launch_bounds__(256) swiglu(float* __restrict__ G, const float* __restrict__ U, size_t n4) {
    const size_t i = (size_t)blockIdx.x * 256 + threadIdx.x;
    if (i >= n4) return;
    float4 g = ((float4*)G)[i]; const float4 u = ((const float4*)U)[i];
    g.x = g.x / (1.f + expf(-g.x)) * u.x; g.y = g.y / (1.f + expf(-g.y)) * u.y; g.z = g.z / (1.f + expf(-g.z)) * u.z; g.w = g.w / (1.f + expf(-g.w)) * u.w;
    ((float4*)G)[i] = g;
}
}

extern "C" void kernel_launch(void* const* d_in, const int* in_sizes, int n_in, void* d_out, int out_size, void* d_ws, size_t ws_size, hipStream_t stream) {
    using namespace nv;
    const float* x = (const float*)d_in[0];
    const float* w_in = (const float*)d_in[1];
    const float* w_out = (const float*)d_in[2];
    const float* lbl = (const float*)d_in[3];
    const float* hg_g = (const float*)d_in[4];
    const float* ln1_g = (const float*)d_in[5];
    const float* ln1_b = (const float*)d_in[6];
    const float* w_gate = (const float*)d_in[7];
    const float* w_up = (const float*)d_in[8];
    const float* w_down = (const float*)d_in[9];
    const float* ln2_g = (const float*)d_in[10];
    const float* ln2_b = (const float*)d_in[11];
    float* out = (float*)d_out;
    float* ws = (float*)d_ws;
    float* proj = ws;
    float* cat = proj + (size_t)S * DP;
    float* obuf = cat + (size_t)S * D;
    float* mix = obuf + (size_t)S * 512;
    float* x1 = mix + (size_t)S * D;
    float* Gb = x1 + (size_t)S * D;
    float* Ub = Gb + (size_t)S * FF;
    for (int b = 0; b < NB; ++b) {
        const float* xb = x + (size_t)b * S * D;
        float* ob = out + (size_t)b * S * D;
        hipLaunchKernelGGL(sgemm, dim3((DP + 127) / 128, S / 128), dim3(256), 0, stream, xb, D, w_in, DP, proj, DP, S, DP, D);
        hipLaunchKernelGGL(dsa_naive, dim3(S), dim3(256), 0, stream, (const float*)proj, cat);
        hipLaunchKernelGGL(hgrn_naive, dim3(4), dim3(128), 0, stream, (const float*)proj, lbl, obuf);
        hipLaunchKernelGGL(hgrn_post, dim3(S), dim3(256), 0, stream, (const float*)obuf, (const float*)proj, hg_g, cat);
        hipLaunchKernelGGL(sgemm, dim3(D / 128, S / 128), dim3(256), 0, stream, (const float*)cat, D, w_out, D, mix, D, S, D, D);
        hipLaunchKernelGGL(ln_res, dim3(S), dim3(256), 0, stream, xb, (const float*)mix, ln1_g, ln1_b, x1);
        hipLaunchKernelGGL(sgemm, dim3(FF / 128, S / 128), dim3(256), 0, stream, (const float*)x1, D, w_gate, FF, Gb, FF, S, FF, D);
        hipLaunchKernelGGL(sgemm, dim3(FF / 128, S / 128), dim3(256), 0, stream, (const float*)x1, D, w_up, FF, Ub, FF, S, FF, D);
        hipLaunchKernelGGL(swiglu, dim3((unsigned)(((size_t)S * FF / 4 + 255) / 256)), dim3(256), 0, stream, Gb, (const float*)Ub, (size_t)S * FF / 4);
        hipLaunchKernelGGL(sgemm, dim3(D / 128, S / 128), dim3(256), 0, stream, (const float*)Gb, FF, w_down, D, mix, D, S, D, FF);
        hipLaunchKernelGGL(ln_res, dim3(S), dim3(256), 0, stream, (const float*)x1, (const float*)mix, ln2_g, ln2_b, ob);
    }
}
```
